# Optimizing an MI355X kernel written in HIP

```python
import jax, jax.numpy as jnp
from jax import lax
import numpy as np

D_MODEL = 1024
BATCH = 1
SEQ = 16384
DEPTH = 4
DEC_BATCH = 2
DEC_SEQ = 8192
PAST_LEN = 128

GRID_W = 64
NA_HEADS = 16
HEAD_DIM = D_MODEL // NA_HEADS
MAX_KH = 8
KW = 16
N_MIXERS = 2
CHUNK = 128
SG_GROUPS = 16
SG_WIDTH = D_MODEL
SG_GROUP_DIM = SG_WIDTH // SG_GROUPS
D_FF = ((8 * D_MODEL + 3 * 256 - 1) // (3 * 256)) * 256
N_NA_LAYERS = (DEPTH + N_MIXERS - 1) // N_MIXERS
N_SG_LAYERS = DEPTH // N_MIXERS
ALPHA = (2 * DEPTH) ** 0.25
BETA = (8 * DEPTH) ** -0.25
LN_EPS = 1e-5

kernel_name = "hybrid_natten_gmlp_deepnorm_encoder"


def layer_norm(x, g, b):
    xf = x.astype(jnp.float32)
    mu = jnp.mean(xf, axis=-1, keepdims=True)
    var = jnp.mean(jnp.square(xf - mu), axis=-1, keepdims=True)
    y = (xf - mu) * lax.rsqrt(var + LN_EPS)
    return (y * g.astype(jnp.float32) + b.astype(jnp.float32)).astype(x.dtype)


def neighbourhood_attention(x, w_in, rpb, w_out):
    B, T, D = x.shape
    rows = T // GRID_W
    kh = min(MAX_KH, rows)
    q, k, v = jnp.split(x @ w_in, 3, axis=-1)
    q = q.reshape(B, rows, GRID_W, NA_HEADS, HEAD_DIM) * (HEAD_DIM ** -0.5)
    k = k.reshape(B, rows, GRID_W, NA_HEADS, HEAD_DIM)
    v = v.reshape(B, rows, GRID_W, NA_HEADS, HEAD_DIM)
    r_ar = np.arange(rows)
    row_start = np.clip(r_ar - kh // 2, 0, rows - kh)
    dr_idx = row_start[:, None] + np.arange(kh)[None, :] - r_ar[:, None] + MAX_KH - 1
    c_ar = np.arange(GRID_W)
    col_start = np.clip(c_ar - KW // 2, 0, GRID_W - KW)
    col_idx = col_start[:, None] + np.arange(KW)[None, :]
    dc_idx = col_idx - c_ar[:, None] + KW - 1
    rpb_c = rpb[:, :, dc_idx]

    def row_fn(args):
        q_r, rs, dr = args
        k_rows = lax.dynamic_slice_in_dim(k, rs, kh, axis=1)
        v_rows = lax.dynamic_slice_in_dim(v, rs, kh, axis=1)
        k_win = k_rows[:, :, col_idx]
        v_win = v_rows[:, :, col_idx]
        bias = jnp.take(rpb_c, dr, axis=1)
        s = jnp.einsum('bchd,bjckhd->bhjck', q_r, k_win).astype(jnp.float32) + bias.astype(jnp.float32)
        p = jax.nn.softmax(s, axis=(2, 4)).astype(v.dtype)
        return jnp.einsum('bhjck,bjckhd->bchd', p, v_win)

    o = lax.map(row_fn, (jnp.moveaxis(q, 1, 0),
                         jnp.asarray(row_start, dtype=jnp.int32),
                         jnp.asarray(dr_idx, dtype=jnp.int32)))
    o = jnp.moveaxis(o, 0, 1).reshape(B, T, D)
    return o @ w_out


def spatial_gating(x, w_in, ln_g, ln_b, w_s, b_s, w_out):
    B, T, D = x.shape
    n_chunks = T // CHUNK
    u, v = jnp.split(jax.nn.gelu(x @ w_in, approximate=False), 2, axis=-1)
    v = layer_norm(v, ln_g, ln_b).reshape(B, n_chunks, CHUNK, SG_GROUPS, SG_GROUP_DIM)
    v = jnp.einsum('gpq,bnqgc->bnpgc', w_s, v) + b_s.T[None, None, :, :, None]
    return (u * v.reshape(B, T, SG_WIDTH)) @ w_out


def swiglu(x, w_in, w_out):
    g, h = jnp.split(x @ w_in, 2, axis=-1)
    return (jax.nn.silu(g) * h) @ w_out


def trunk(x, na_w_in, na_rpb, na_w_out, sg_w_in, sg_ln_g, sg_ln_b, sg_w_s, sg_b_s, sg_w_out,
          ln_mix_g, ln_mix_b, ffn_w_in, ffn_w_out, ln_ffn_g, ln_ffn_b):
    for i in range(DEPTH):
        j = i // N_MIXERS
        if i % N_MIXERS == 0:
            m = neighbourhood_attention(x, na_w_in[j], na_rpb[j], na_w_out[j])
        else:
            m = spatial_gating(x, sg_w_in[j], sg_ln_g[j], sg_ln_b[j], sg_w_s[j], sg_b_s[j], sg_w_out[j])
        x = layer_norm(ALPHA * x + m, ln_mix_g[i], ln_mix_b[i])
        x = layer_norm(ALPHA * x + swiglu(x, ffn_w_in[i], ffn_w_out[i]), ln_ffn_g[i], ln_ffn_b[i])
    return x


def setup_inputs(seed: int = 0) -> dict:
    key = jax.random.key(seed)
    ks = jax.random.split(key, 24)
    f32 = jnp.float32
    nrm = lambda k, shape, s: jax.random.normal(k, shape, f32) * s
    D = D_MODEL
    x_prompt = nrm(ks[0], (BATCH, SEQ, D), 1.0)
    x_sample = nrm(ks[1], (DEC_BATCH, DEC_SEQ, D), 1.0)
    na_w_in = jnp.concatenate([nrm(ks[2], (N_NA_LAYERS, D, 2 * D), D ** -0.5),
                               nrm(ks[3], (N_NA_LAYERS, D, D), BETA * D ** -0.5)], axis=-1)
    na_rpb = nrm(ks[4], (N_NA_LAYERS, NA_HEADS, 2 * MAX_KH - 1, 2 * KW - 1), 0.1)
    na_w_out = nrm(ks[5], (N_NA_LAYERS, D, D), BETA * D ** -0.5)
    sg_w_in = nrm(ks[6], (N_SG_LAYERS, D, 2 * SG_WIDTH), D ** -0.5)
    sg_ln_g = 1.0 + nrm(ks[7], (N_SG_LAYERS, SG_WIDTH), 0.01)
    sg_ln_b = nrm(ks[8], (N_SG_LAYERS, SG_WIDTH), 0.01)
    sg_w_s = nrm(ks[9], (N_SG_LAYERS, SG_GROUPS, CHUNK, CHUNK), CHUNK ** -0.5)
    sg_b_s = 1.0 + nrm(ks[10], (N_SG_LAYERS, SG_GROUPS, CHUNK), 0.1)
    sg_w_out = nrm(ks[11], (N_SG_LAYERS, SG_WIDTH, D), BETA * SG_WIDTH ** -0.5)
    ln_mix_g = 1.0 + nrm(ks[12], (DEPTH, D), 0.01)
    ln_mix_b = nrm(ks[13], (DEPTH, D), 0.01)
    ffn_w_in = nrm(ks[14], (DEPTH, D, 2 * D_FF), D ** -0.5)
    ffn_w_out = nrm(ks[15], (DEPTH, D_FF, D), BETA * D_FF ** -0.5)
    ln_ffn_g = 1.0 + nrm(ks[16], (DEPTH, D), 0.01)
    ln_ffn_b = nrm(ks[17], (DEPTH, D), 0.01)
    return {"x_prompt": x_prompt, "x_sample": x_sample,
            "na_w_in": na_w_in, "na_rpb": na_rpb, "na_w_out": na_w_out,
            "sg_w_in": sg_w_in, "sg_ln_g": sg_ln_g, "sg_ln_b": sg_ln_b,
            "sg_w_s": sg_w_s, "sg_b_s": sg_b_s, "sg_w_out": sg_w_out,
            "ln_mix_g": ln_mix_g, "ln_mix_b": ln_mix_b,
            "ffn_w_in": ffn_w_in, "ffn_w_out": ffn_w_out,
            "ln_ffn_g": ln_ffn_g, "ln_ffn_b": ln_ffn_b}


def reference(x_prompt, x_sample, na_w_in, na_rpb, na_w_out, sg_w_in, sg_ln_g, sg_ln_b,
              sg_w_s, sg_b_s, sg_w_out, ln_mix_g, ln_mix_b, ffn_w_in, ffn_w_out,
              ln_ffn_g, ln_ffn_b):
    y_prompt = trunk(x_prompt, na_w_in, na_rpb, na_w_out, sg_w_in, sg_ln_g, sg_ln_b, sg_w_s,
                     sg_b_s, sg_w_out, ln_mix_g, ln_mix_b, ffn_w_in, ffn_w_out, ln_ffn_g, ln_ffn_b)
    y_sample = trunk(x_sample, na_w_in, na_rpb, na_w_out, sg_w_in, sg_ln_g, sg_ln_b, sg_w_s,
                     sg_b_s, sg_w_out, ln_mix_g, ln_mix_b, ffn_w_in, ffn_w_out, ln_ffn_g, ln_ffn_b)
    return (y_prompt, y_sample)
```

```cpp
#include <hip/hip_runtime.h>
#include <hip/hip_cooperative_groups.h>
#include <cstdio>
#include <cstdint>
namespace cg = cooperative_groups;
namespace pg8 {
#define PG8_LAS __attribute__((address_space(3)))
typedef unsigned short bf16_t;
typedef short bf16x8 __attribute__((ext_vector_type(8)));
typedef float f32x4 __attribute__((ext_vector_type(4)));
typedef unsigned u32x4 __attribute__((ext_vector_type(4)));
constexpr int BM = 256, BK = 64, HALF = 128, HTB = HALF * BK * 2  , STAGE_BYTES = 8 * HTB, NXCD = 8, WGM = 8;

__host__ __device__ __forceinline__ int lds_byte(int r, int c) { const int st = (r >> 4) * 2 + (c >> 5), rr = r & 15, cc = c & 31, ob = rr * 64 + cc * 2; return st * 1024 + (ob ^ (((ob >> 9) & 1) << 5)); }
__host__ __device__ __forceinline__ void stage_rc(int b, int& R, int& C) { const int st = b / 1024, sb = b % 1024, swz = sb ^ (((sb >> 9) & 1) << 5); R = (st >> 1) * 16 + swz / 64; C = (st & 1) * 32 + (swz % 64) / 2; }
__host__ __device__ __forceinline__ int perm32(int rho) { const int n = rho >> 4, i = rho & 15; return 8 * (i >> 2) + 4 * n + (i & 3); }

struct Unit { int pm, pn; };
struct Gemm { const bf16_t* A; const bf16_t* Bt; int M, N, K; };

struct StaticOrder {
    int nM, nN, nwg, G, c;
    __host__ __device__ void init(int M, int N, int G_, int c_) { nM = M / BM; nN = N / BM; nwg = nM * nN; G = G_; c = c_; }
    __host__ __device__ bool next(int i, Unit& u) const {
        const long L = (long)i * G + c; if (L >= nwg) return false;
        int wgid = (int)L; { const int q = nwg / NXCD, r = nwg % NXCD, xcd = wgid % NXCD, off = wgid / NXCD; wgid = (xcd < r ? xcd * (q + 1) : r * (q + 1) + (xcd - r) * q) + off; }
        const int nig = WGM * nN, gid = wgid / nig, fm = gid * WGM, gsz = (nM - fm) < WGM ? (nM - fm) : WGM;
        u.pm = fm + ((wgid % nig) % gsz); u.pn = (wgid % nig) / gsz; return true;
    }
    __device__ __forceinline__ void a_ready(const Unit&) const {}
    __device__ __forceinline__ void done(const Unit&) const {}
};

__device__ __forceinline__ unsigned cvt_pk_bf16(float lo, float hi) { unsigned r; asm volatile("v_cvt_pk_bf16_f32 %0, %1, %2" : "=v"(r) : "v"(lo), "v"(hi)); return r; }
typedef float f32x2 __attribute__((ext_vector_type(2)));
__device__ __forceinline__ f32x2 gelu_pk(f32x2 v) {
    const f32x2 av = __builtin_elementwise_abs(v), d = av * 0.2316418882f + 1.0f;
    f32x2 t; t.x = __builtin_amdgcn_rcpf(d.x); t.y = __builtin_amdgcn_rcpf(d.y);
    f32x2 q = t * 0.5307027145f + (-0.7265760135f); q = q * t + 0.7107068705f; q = q * t + (-0.142248368f); q = q * t + 0.127414796f; q = q * t;
    const f32x2 s = (v * v) * (-0.72134752044f);
    f32x2 e; e.x = __builtin_amdgcn_exp2f(s.x); e.y = __builtin_amdgcn_exp2f(s.y);
    const f32x2 m = v * (q * e), r = v - m;
    f32x2 o; o.x = v.x < 0.f ? m.x : r.x; o.y = v.y < 0.f ? m.y : r.y; return o;
}

template <int ACT  > struct EpiBf16 {
    static constexpr bool PERM = true, AFTER_DRAIN = false; static_assert(ACT == 0 || ACT == 1, "EpiBf16: ACT is 0 (none) or 1 (gelu_pk)");
    bf16_t* O; int ldc; const float* bias; int split_cols; size_t split_stride; float scale0;
    __device__ __forceinline__ void operator()(const f32x4 (&acc)[2][2][4][2], const Unit& u, int wr, int wc, int fr, int fq) const {
        const int row0 = u.pm * BM + wr * 64 + fr; int colt = u.pn * BM; bf16_t* base = O;
        float sc = 1.f; if (split_cols) { const int t = colt / split_cols; base += (size_t)t * split_stride; colt -= t * split_cols; if (t == 0) sc = scale0; }
        const int col0 = colt + wc * 32 + 8 * fq, bcol0 = u.pn * BM + wc * 32 + 8 * fq;
        f32x4 bv[2][2];
#pragma unroll
        for (int bj = 0; bj < 2; ++bj)
#pragma unroll
            for (int n = 0; n < 2; ++n) bv[bj][n] = bias ? *(const f32x4*)(bias + bcol0 + bj * HALF + 4 * n) : (f32x4){0.f, 0.f, 0.f, 0.f};
#pragma unroll
        for (int ai = 0; ai < 2; ++ai)
#pragma unroll
            for (int m = 0; m < 4; ++m) { bf16_t* rowp = base + (size_t)(row0 + ai * HALF + m * 16) * ldc + col0;
#pragma unroll
                for (int bj = 0; bj < 2; ++bj) { f32x4 v0 = acc[ai][bj][m][0] + bv[bj][0], v1 = acc[ai][bj][m][1] + bv[bj][1];
                    if (ACT == 1) { f32x2 a = gelu_pk((f32x2){v0[0], v0[1]}), b = gelu_pk((f32x2){v0[2], v0[3]}), c = gelu_pk((f32x2){v1[0], v1[1]}), d = gelu_pk((f32x2){v1[2], v1[3]});
                        v0 = (f32x4){a.x, a.y, b.x, b.y}; v1 = (f32x4){c.x, c.y, d.x, d.y}; }
                    v0 = v0 * sc; v1 = v1 * sc; u32x4 w; w.x = cvt_pk_bf16(v0[0], v0[1]); w.y = cvt_pk_bf16(v0[2], v0[3]); w.z = cvt_pk_bf16(v1[0], v1[1]); w.w = cvt_pk_bf16(v1[2], v1[3]);
                    *(u32x4*)(rowp + bj * HALF) = w; } }
    }
};

struct EpiSwiglu {
    static constexpr bool PERM = true, AFTER_DRAIN = false;
    bf16_t* H; int ldh;
    __device__ __forceinline__ void operator()(const f32x4 (&acc)[2][2][4][2], const Unit& u, int wr, int wc, int fr, int fq) const {
        const int row0 = u.pm * BM + wr * 64 + fr; const int col0 = u.pn * HALF + wc * 32 + 8 * fq;
#pragma unroll
        for (int ai = 0; ai < 2; ++ai)
#pragma unroll
            for (int m = 0; m < 4; ++m) { bf16_t* rowp = H + (size_t)(row0 + ai * HALF + m * 16) * ldh + col0;
                float o[8];
#pragma unroll
                for (int n = 0; n < 2; ++n)
#pragma unroll
                    for (int e = 0; e < 4; ++e) { const float g = acc[ai][0][m][n][e], h = acc[ai][1][m][n][e];
                        const float s = __builtin_amdgcn_rcpf(1.0f + __builtin_amdgcn_exp2f(-1.4426950408889634f * g));
                        o[n * 4 + e] = g * s * h; }
                u32x4 w; w.x = cvt_pk_bf16(o[0], o[1]); w.y = cvt_pk_bf16(o[2], o[3]); w.z = cvt_pk_bf16(o[4], o[5]); w.w = cvt_pk_bf16(o[6], o[7]);
                *(u32x4*)rowp = w; }
    }
};
struct EpiRes {
    static constexpr bool PERM = false, AFTER_DRAIN = false;
    const float* base0; const float* base1; int pm_split; float* out; int ldc; float alpha;
    __device__ __forceinline__ void operator()(const f32x4 (&acc)[2][2][4][2], const Unit& u, int wr, int wc, int fr, int fq) const {
        const float* base = (u.pm < pm_split) ? base0 : base1;
        const int col0 = u.pn * BM + wc * 32 + 4 * fq;
#pragma unroll
        for (int ai = 0; ai < 2; ++ai)
#pragma unroll
            for (int m = 0; m < 4; ++m) { const size_t off = (size_t)(u.pm * BM + ai * HALF + wr * 64 + m * 16 + fr) * ldc + col0;
#pragma unroll
                for (int bj = 0; bj < 2; ++bj)
#pragma unroll
                    for (int n = 0; n < 2; ++n) { const f32x4 bs = *(const f32x4*)(base + off + bj * HALF + n * 16);
                        *(f32x4*)(out + off + bj * HALF + n * 16) = bs * alpha + acc[ai][bj][m][n]; }
                if (m & 1) asm volatile("" ::: "memory"); }
    }
};
template <class Epi, class Sched, bool ALIGN_EPI = false, bool SP2 = false>
__device__ __forceinline__ void gemm_phase(PG8_LAS unsigned char* lds, const Gemm g, const Sched& S, const Epi& E) {
    int tid_l = threadIdx.x; asm volatile("" : "+v"(tid_l));
    const int tid = tid_l, wid = __builtin_amdgcn_readfirstlane(tid >> 6), lane = tid & 63, wr = wid >> 2, wc = wid & 3, fr = lane & 15, fq = lane >> 4;
    const int K = g.K, nt = K / BK;
    unsigned voffA[2], voffB[2];
#pragma unroll
    for (int i = 0; i < 2; ++i) { int R, C; stage_rc(tid * 16 + i * 8192, R, C); const int Rb = Epi::PERM ? ((R & ~31) + perm32(R & 31)) : R;
        voffA[i] = (unsigned)(R * K + C) * 2u; voffB[i] = (unsigned)(Rb * K + C) * 2u; }
    const size_t kstep = (size_t)(BK * 2);
    const size_t hstep = (size_t)HALF * K * 2;
    const size_t tstep = 2 * hstep;
    const unsigned ldsw = (unsigned)wid * 1024u;
    const int aoff = lds_byte(wr * 64 + fr, fq * 8), boff = lds_byte(wc * 32 + fr, fq * 8);
#define PG8_SA(b, h) (((b) * 2 + (h)) * HTB)
#define PG8_SB(b, h) ((4 + (b) * 2 + (h)) * HTB)
#define PG8_STAGE(bufoff, gbase, voff) do { _Pragma("unroll") for (int _i = 0; _i < 2; ++_i) \
        __builtin_amdgcn_global_load_lds((const unsigned*)((const char*)(gbase) + (voff)[_i]), (PG8_LAS unsigned*)(lds + (bufoff) + ldsw + _i * 8192), 16, 0, 0); } while (0)
#define PG8_LDA(dst, b, h) do { _Pragma("unroll") for (int m = 0; m < 4; ++m) _Pragma("unroll") for (int k = 0; k < 2; ++k) dst[m][k] = *(const PG8_LAS bf16x8*)(lds + PG8_SA(b, h) + aoff + m * 2048 + k * 1024); } while (0)
#define PG8_LDB(dst, b, h) do { _Pragma("unroll") for (int n = 0; n < 2; ++n) _Pragma("unroll") for (int k = 0; k < 2; ++k) dst[n][k] = *(const PG8_LAS bf16x8*)(lds + PG8_SB(b, h) + boff + n * 2048 + k * 1024); } while (0)
#define PG8_MMA(ai, bj, At, Bt) do { __builtin_amdgcn_s_setprio(1); _Pragma("unroll") for (int m = 0; m < 4; ++m) _Pragma("unroll") for (int n = 0; n < 2; ++n) _Pragma("unroll") for (int k = 0; k < 2; ++k) \
        acc[ai][bj][m][n] = __builtin_amdgcn_mfma_f32_16x16x32_bf16(Bt[n][k], At[m][k], acc[ai][bj][m][n], 0, 0, 0); __builtin_amdgcn_s_setprio(0); } while (0)
#define PG8_WAIT_V(n) asm volatile("s_waitcnt vmcnt(" #n ")" ::: "memory")
#define PG8_WAIT_L(n) asm volatile("s_waitcnt lgkmcnt(" #n ")" ::: "memory")
#define PG8_BAR __builtin_amdgcn_s_barrier()
#define PG8_SCHED __builtin_amdgcn_sched_barrier(0)
    Unit cur, nxt; int ui = 0;
    if (!S.next(0, cur)) return;
    f32x4 acc[2][2][4][2];
#pragma unroll
    for (int a = 0; a < 2; ++a)
#pragma unroll
        for (int b = 0; b < 2; ++b)
#pragma unroll
            for (int m = 0; m < 4; ++m)
#pragma unroll
                for (int n = 0; n < 2; ++n) acc[a][b][m][n] = (f32x4){0.f, 0.f, 0.f, 0.f};
    bf16x8 At[4][2], B0[2][2], B1[2][2];
    const char* cA = (const char*)g.A + (size_t)cur.pm * tstep; const char* cB = (const char*)g.Bt + (size_t)cur.pn * tstep;
    S.a_ready(cur);
    if constexpr (SP2) {
        PG8_STAGE(PG8_SB(0, 0), cB, voffB); PG8_STAGE(PG8_SB(0, 1), cB + hstep, voffB); PG8_STAGE(PG8_SA(0, 0), cA, voffA); PG8_STAGE(PG8_SA(0, 1), cA + hstep, voffA);
        if (wr == 1) PG8_BAR;
        PG8_WAIT_V(2); PG8_BAR;
        PG8_STAGE(PG8_SB(1, 0), cB + kstep, voffB); PG8_STAGE(PG8_SA(1, 0), cA + kstep, voffA); PG8_STAGE(PG8_SB(1, 1), cB + hstep + kstep, voffB);
        PG8_WAIT_V(6); PG8_BAR;
    } else {
        PG8_STAGE(PG8_SB(0, 0), cB, voffB); PG8_STAGE(PG8_SA(0, 0), cA, voffA); PG8_STAGE(PG8_SB(0, 1), cB + hstep, voffB); PG8_STAGE(PG8_SA(0, 1), cA + hstep, voffA);
        if (wr == 1) PG8_BAR;
        PG8_WAIT_V(4); PG8_BAR;
        PG8_STAGE(PG8_SB(1, 0), cB + kstep, voffB); PG8_STAGE(PG8_SA(1, 0), cA + kstep, voffA); PG8_STAGE(PG8_SB(1, 1), cB + hstep + kstep, voffB);
        PG8_WAIT_V(6); PG8_BAR;
    }
    for (;;) {
        const bool has_next = S.next(ui + 1, nxt);
        const char* nA = has_next ? (const char*)g.A + (size_t)nxt.pm * tstep : cA; const char* nB = has_next ? (const char*)g.Bt + (size_t)nxt.pn * tstep : cB;
        for (int t = 0; t < nt; t += 2) {
            const bool last = (t == nt - 2);
            const char* a1 = cA + (size_t)(t + 1) * kstep;
            const char* a2 = last ? nA : cA + (size_t)(t + 2) * kstep; const char* b2 = last ? nB : cB + (size_t)(t + 2) * kstep;
            const char* a3 = a2 + kstep; const char* b3 = b2 + kstep;
            if (last && has_next) S.a_ready(nxt);
            if constexpr (SP2) {
            PG8_LDB(B0, 0, 0); PG8_LDB(B1, 0, 1); PG8_SCHED; PG8_LDA(At, 0, 0); PG8_STAGE(PG8_SA(1, 1), a1 + hstep, voffA);
            PG8_WAIT_V(8); PG8_WAIT_L(0); PG8_BAR; PG8_MMA(0, 0, At, B0); PG8_MMA(0, 1, At, B1); PG8_BAR; PG8_SCHED;
            PG8_LDA(At, 0, 1); PG8_STAGE(PG8_SB(0, 0), b2, voffB); PG8_STAGE(PG8_SB(0, 1), b2 + hstep, voffB); PG8_STAGE(PG8_SA(0, 0), a2, voffA);
            PG8_WAIT_V(8); PG8_WAIT_L(0); PG8_BAR; PG8_MMA(1, 0, At, B0); PG8_MMA(1, 1, At, B1); PG8_BAR; PG8_SCHED;
            PG8_LDB(B0, 1, 0); PG8_LDB(B1, 1, 1); PG8_SCHED; PG8_LDA(At, 1, 0); PG8_STAGE(PG8_SA(0, 1), a2 + hstep, voffA);
            PG8_WAIT_V(8); PG8_WAIT_L(0); PG8_BAR; PG8_MMA(0, 0, At, B0); PG8_MMA(0, 1, At, B1); PG8_BAR; PG8_SCHED;
            PG8_LDA(At, 1, 1); PG8_STAGE(PG8_SB(1, 0), b3, voffB); PG8_STAGE(PG8_SB(1, 1), b3 + hstep, voffB); PG8_STAGE(PG8_SA(1, 0), a3, voffA);
            PG8_WAIT_V(8); PG8_WAIT_L(0); PG8_BAR; PG8_MMA(1, 0, At, B0); PG8_MMA(1, 1, At, B1); PG8_BAR; PG8_SCHED;
            } else {
            PG8_LDB(B0, 0, 0); PG8_SCHED; PG8_LDA(At, 0, 0); PG8_STAGE(PG8_SA(1, 1), a1 + hstep, voffA);
            PG8_WAIT_L(8); PG8_BAR; PG8_WAIT_L(0); PG8_MMA(0, 0, At, B0); PG8_BAR; PG8_SCHED;
            PG8_LDB(B1, 0, 1); PG8_STAGE(PG8_SB(0, 0), b2, voffB);
            PG8_BAR; PG8_WAIT_L(0); PG8_MMA(0, 1, At, B1); PG8_BAR;
            PG8_LDA(At, 0, 1); PG8_STAGE(PG8_SA(0, 0), a2, voffA);
            PG8_BAR; PG8_WAIT_L(0); PG8_MMA(1, 0, At, B0); PG8_BAR; PG8_SCHED;
            PG8_STAGE(PG8_SB(0, 1), b2 + hstep, voffB);
            PG8_WAIT_V(6); PG8_BAR; PG8_MMA(1, 1, At, B1); PG8_BAR;
            PG8_LDB(B0, 1, 0); PG8_SCHED; PG8_LDA(At, 1, 0); PG8_STAGE(PG8_SA(0, 1), a2 + hstep, voffA);
            PG8_WAIT_L(8); PG8_BAR; PG8_WAIT_L(0); PG8_MMA(0, 0, At, B0); PG8_BAR; PG8_SCHED;
            PG8_LDB(B1, 1, 1); PG8_STAGE(PG8_SB(1, 0), b3, voffB);
            PG8_BAR; PG8_WAIT_L(0); PG8_MMA(0, 1, At, B1); PG8_BAR;
            PG8_LDA(At, 1, 1); PG8_STAGE(PG8_SA(1, 0), a3, voffA);
            PG8_BAR; PG8_WAIT_L(0); PG8_MMA(1, 0, At, B0); PG8_BAR; PG8_SCHED;
            PG8_STAGE(PG8_SB(1, 1), b3 + hstep, voffB);
            PG8_WAIT_V(6); PG8_BAR; PG8_MMA(1, 1, At, B1); PG8_BAR;
            }
        }
        if constexpr (ALIGN_EPI) { if (wr == 0) PG8_BAR; }
        if constexpr (!Epi::AFTER_DRAIN) { E(acc, cur, wr, wc, fr, fq); S.done(cur); }
        if (!has_next) break;
#pragma unroll
        for (int a = 0; a < 2; ++a)
#pragma unroll
            for (int b = 0; b < 2; ++b)
#pragma unroll
                for (int m = 0; m < 4; ++m)
#pragma unroll
                    for (int n = 0; n < 2; ++n) acc[a][b][m][n] = (f32x4){0.f, 0.f, 0.f, 0.f};
        cur = nxt; cA = nA; cB = nB; ++ui;
        if constexpr (ALIGN_EPI) { if (wr == 1) PG8_BAR; }
    }
    PG8_WAIT_V(0);
    if constexpr (!ALIGN_EPI) { if (wr == 0) PG8_BAR; }
    PG8_BAR;
    if constexpr (Epi::AFTER_DRAIN) { E.fused(acc, cur, wr, wc, fr, fq, lds, wid, lane); S.done(cur); }
#undef PG8_SA
#undef PG8_SB
#undef PG8_STAGE
#undef PG8_LDA
#undef PG8_LDB
#undef PG8_MMA
#undef PG8_WAIT_V
#undef PG8_WAIT_L
#undef PG8_BAR
#undef PG8_SCHED
}
}

#define GAS __attribute__((address_space(1)))
#define LAS __attribute__((address_space(3)))
typedef unsigned short bf16;
typedef unsigned v4u __attribute__((ext_vector_type(4)));
typedef unsigned v2u __attribute__((ext_vector_type(2)));
typedef float f32x4 __attribute__((ext_vector_type(4)));
typedef short bf16x8 __attribute__((ext_vector_type(8)));
typedef short bf16x4 __attribute__((ext_vector_type(4)));

constexpr int NWAVES = 8, NTHREADS = 512;
constexpr int D = 1024, MTOK = 32768, DFF = 2816, NPROMPT = 16384;
constexpr float LN_EPS = 1e-5f;
constexpr float ALPHA = 1.681792830507429f;
constexpr float LOG2E = 1.4426950408889634f;
constexpr float QSCALE = 0.125f * LOG2E;

constexpr size_t MiB = 1u << 20;
constexpr size_t WS_CTL = 0;
constexpr size_t WS_XN = 1 * MiB;
constexpr size_t WS_S0 = 65 * MiB;
constexpr size_t WS_S1 = WS_S0 + 64 * MiB, WS_S2 = WS_S0 + 128 * MiB;
constexpr size_t WS_WMIX = 257 * MiB;
constexpr size_t WO_NAIN = 0;
constexpr size_t WO_NAOUT = WO_NAIN + (size_t)2 * 3072 * 1024;
constexpr size_t WO_SGIN = WO_NAOUT + (size_t)2 * 1024 * 1024;
constexpr size_t WO_SGOUT = WO_SGIN + (size_t)2 * 2048 * 1024;
constexpr size_t WO_SGWS = WO_SGOUT + (size_t)2 * 1024 * 1024;
constexpr size_t WO_MIXEND = WO_SGWS + (size_t)2 * 16 * 128 * 128;
constexpr size_t WS_WFFN = WS_WMIX + ((WO_MIXEND * 2 + MiB - 1) / MiB) * MiB;
constexpr size_t WF_IN = 0, WF_OUT = (size_t)5632 * 1024;
constexpr size_t WS_END = WS_WFFN + ((size_t)(5632 * 1024 + 1024 * 2816) * 2 + MiB - 1) / MiB * MiB;
static_assert(WS_END <= (size_t)352 * MiB, "workspace budget");

constexpr int LDS_BYTES = 147456;

__device__ __forceinline__ unsigned f2bf(float f) { unsigned u = __builtin_bit_cast(unsigned, f); return (u + 0x7fffu + ((u >> 16) & 1u)) >> 16; }
__device__ __forceinline__ unsigned pk2(float lo, float hi) { return f2bf(lo) | (f2bf(hi) << 16); }
__device__ __forceinline__ float bf2f(unsigned short b) { return __builtin_bit_cast(float, (unsigned)b << 16); }
__device__ __forceinline__ float bflo(unsigned w) { return __builtin_bit_cast(float, w << 16); }
__device__ __forceinline__ float bfhi(unsigned w) { return __builtin_bit_cast(float, w & 0xffff0000u); }
__device__ __forceinline__ float wave_sum(float v) {
#pragma unroll
    for (int o = 1; o < 64; o <<= 1) v += __shfl_xor(v, o);
    return v;
}
#define LDS_WAIT() asm volatile("s_waitcnt lgkmcnt(0)" ::: "memory")

__device__ __forceinline__ void transpose_item(const float* W, int K, int N, bf16* WT, int out_row0, LAS float* scr, int k0, int n0, int lane) {
#pragma unroll 8
    for (int i = 0; i < 32; ++i) { const int kk = 2 * i + (lane >> 5); scr[kk * 33 + (lane & 31)] = W[(size_t)(k0 + kk) * N + n0 + (lane & 31)]; }
    LDS_WAIT(); asm volatile("" ::: "memory");
    const int c = lane & 7;
#pragma unroll
    for (int j = 0; j < 4; ++j) { const int n = (lane >> 3) + 8 * j; const LAS float* s = scr + (8 * c) * 33 + n;
        v4u o; o.x = pk2(s[0 * 33], s[1 * 33]); o.y = pk2(s[2 * 33], s[3 * 33]); o.z = pk2(s[4 * 33], s[5 * 33]); o.w = pk2(s[6 * 33], s[7 * 33]);
        *(v4u*)(WT + (size_t)(out_row0 + n) * K + k0 + 8 * c) = o; }
    LDS_WAIT(); asm volatile("" ::: "memory");
}
template <int MODE>
__device__ __forceinline__ void convert_matrix(const float* W, int K, int N, bf16* WT, LAS float* scr, int gw, int NGW, int lane) {
    const int nblk = N / 32, items = (K / 64) * nblk;
    for (int it = gw; it < items; it += NGW) {
        const int kb = it / nblk, nb = it % nblk, n0 = 32 * nb;
        int orow = n0;
        if (MODE == 1) { const int half = (n0 >= DFF) ? 1 : 0; const int j = n0 - half * DFF; orow = 256 * (j >> 7) + 128 * half + (j & 127); }
        transpose_item(W, K, N, WT, orow, scr, 64 * kb, n0, lane);
    }
}

__device__ __forceinline__ void ln_rows(float* X, bf16* XN, const float* gam, const float* bet, int gw, int NGW, int lane) {
    f32x4 gv[4], bv[4];
#pragma unroll
    for (int j = 0; j < 4; ++j) { gv[j] = ((const f32x4*)gam)[lane + 64 * j]; bv[j] = ((const f32x4*)bet)[lane + 64 * j]; }
    for (int m = gw; m < MTOK; m += NGW) {
        f32x4* xr = (f32x4*)(X + (size_t)m * D) + lane;
        f32x4 v[4]; float s = 0.f;
#pragma unroll
        for (int j = 0; j < 4; ++j) { v[j] = xr[64 * j]; s += (v[j].x + v[j].y) + (v[j].z + v[j].w); }
        const float mean = wave_sum(s) * (1.f / D); float s2 = 0.f;
#pragma unroll
        for (int j = 0; j < 4; ++j) { v[j] = v[j] - mean; s2 += (v[j].x * v[j].x + v[j].y * v[j].y) + (v[j].z * v[j].z + v[j].w * v[j].w); }
        const float rstd = 1.f / sqrtf(wave_sum(s2) * (1.f / D) + LN_EPS);
        unsigned long long* o8 = (unsigned long long*)(XN + (size_t)m * D) + lane;
#pragma unroll
        for (int j = 0; j < 4; ++j) { const f32x4 y = v[j] * rstd * gv[j] + bv[j]; xr[64 * j] = y;
            o8[64 * j] = (unsigned long long)pk2(y.x, y.y) | ((unsigned long long)pk2(y.z, y.w) << 32); }
    }
}

__device__ __forceinline__ void attn_phase(bf16* QO, const bf16* Kb, const bf16* VT, const float* rpb, LAS unsigned char* lds, int tid, int wave, int lane, int G, int blk) {
    LAS float* tab = (LAS float*)(lds + 1024);
    for (int i = tid; i < 16 * 15 * 31; i += NTHREADS) tab[i] = rpb[i] * LOG2E;
    __syncthreads();
    const int q = lane & 15, rq = lane >> 4;
    const int b = wave & 3, sub = wave >> 2;
    const int kc0 = (b == 0) ? 0 : (b == 1) ? 8 : (b == 2) ? 24 : 32;
    const int c = 16 * b + q;
    int cs = c - 8; cs = cs < 0 ? 0 : (cs > 48 ? 48 : cs);
    for (int bu = blk; bu < 4096; bu += G) {
        const int h = bu & 15, R = (bu >> 4) * 2 + sub;
        int base, rows;
        if (R < 256) { base = 0; rows = 256; } else if (R < 384) { base = 256; rows = 128; } else { base = 384; rows = 128; }
        const int r = R - base; int rs = r - 4; rs = rs < 0 ? 0 : (rs > rows - 8 ? rows - 8 : rs);
        const size_t tokq = (size_t)R * 64 + c;
        bf16x8 Qf[2];
#pragma unroll
        for (int dd = 0; dd < 2; ++dd) Qf[dd] = *(const bf16x8*)(QO + tokq * D + h * 64 + 32 * dd + 8 * rq);
        f32x4 S[8][2];
#pragma unroll
        for (int j = 0; j < 8; ++j) {
            const int Rk = base + rs + j;
#pragma unroll
            for (int t = 0; t < 2; ++t) {
                const size_t tokk = (size_t)Rk * 64 + kc0 + 16 * t + q;
                const bf16x8 k0 = *(const bf16x8*)(Kb + tokk * D + h * 64 + 8 * rq);
                const bf16x8 k1 = *(const bf16x8*)(Kb + tokk * D + h * 64 + 32 + 8 * rq);
                f32x4 s = (f32x4){0.f, 0.f, 0.f, 0.f};
                s = __builtin_amdgcn_mfma_f32_16x16x32_bf16(k0, Qf[0], s, 0, 0, 0);
                s = __builtin_amdgcn_mfma_f32_16x16x32_bf16(k1, Qf[1], s, 0, 0, 0);
                S[j][t] = s;
            }
        }
        float mx = -INFINITY;
#pragma unroll
        for (int j = 0; j < 8; ++j) {
            const int dr = rs + j - r + 7;
            const LAS float* trow = tab + h * 465 + dr * 31 + 15 - c;
#pragma unroll
            for (int t = 0; t < 2; ++t)
#pragma unroll
                for (int e = 0; e < 4; ++e) {
                    const int kc = kc0 + 16 * t + 4 * rq + e;
                    const bool valid = (kc >= cs) && (kc < cs + 16);
                    const float bias = trow[valid ? kc : c];
                    const float v = valid ? (S[j][t][e] + bias) : -INFINITY;
                    S[j][t][e] = v; mx = fmaxf(mx, v);
                }
        }
        mx = fmaxf(mx, __shfl_xor(mx, 16)); mx = fmaxf(mx, __shfl_xor(mx, 32));
        float l = 0.f;
#pragma unroll
        for (int j = 0; j < 8; ++j)
#pragma unroll
            for (int t = 0; t < 2; ++t)
#pragma unroll
                for (int e = 0; e < 4; ++e) { const float p = __builtin_amdgcn_exp2f(S[j][t][e] - mx); S[j][t][e] = p; l += p; }
        l += __shfl_xor(l, 16); l += __shfl_xor(l, 32);
        f32x4 Oa[4];
#pragma unroll
        for (int db = 0; db < 4; ++db) Oa[db] = (f32x4){0.f, 0.f, 0.f, 0.f};
#pragma unroll
        for (int j = 0; j < 8; ++j) {
            const int Rk = base + rs + j;
            v4u pw; pw.x = pk2(S[j][0][0], S[j][0][1]); pw.y = pk2(S[j][0][2], S[j][0][3]); pw.z = pk2(S[j][1][0], S[j][1][1]); pw.w = pk2(S[j][1][2], S[j][1][3]);
            const bf16x8 Pf = __builtin_bit_cast(bf16x8, pw);
            const size_t tok0 = (size_t)Rk * 64 + kc0 + 4 * rq;
#pragma unroll
            for (int db = 0; db < 4; ++db) {
                const bf16* vp = VT + (size_t)(h * 64 + 16 * db + q) * MTOK + tok0;
                const v2u lo = *(const v2u*)vp, hi = *(const v2u*)(vp + 16);
                v4u vw; vw.x = lo.x; vw.y = lo.y; vw.z = hi.x; vw.w = hi.y;
                Oa[db] = __builtin_amdgcn_mfma_f32_16x16x32_bf16(__builtin_bit_cast(bf16x8, vw), Pf, Oa[db], 0, 0, 0);
            }
        }
        const float inv = 1.0f / l;
#pragma unroll
        for (int db = 0; db < 4; ++db) {
            v2u w; w.x = pk2(Oa[db][0] * inv, Oa[db][1] * inv); w.y = pk2(Oa[db][2] * inv, Oa[db][3] * inv);
            *(v2u*)(QO + tokq * D + h * 64 + 16 * db + 4 * rq) = w;
        }
    }
}

constexpr int SG_TS = 136;
__device__ __forceinline__ void sg_phase(bf16* U, const bf16* Vb, const bf16* WsB, const float* bs, const float* lng, const float* lnb, LAS unsigned char* lds, int tid, int wave, int lane, int G, int blk) {
    LAS float* st = (LAS float*)lds;
    LAS bf16* T = (LAS bf16*)(lds + 1024);
    const int q = lane & 15, rq = lane >> 4;
    for (int n = blk; n < MTOK / 128; n += G) {
#pragma unroll 4
        for (int rr = 0; rr < 16; ++rr) {
            const int row = 16 * wave + rr;
            const v4u* p = (const v4u*)(Vb + (size_t)(128 * n + row) * D + lane * 16);
            const v4u a = p[0], b2 = p[1];
            float x[16];
            x[0] = bflo(a.x); x[1] = bfhi(a.x); x[2] = bflo(a.y); x[3] = bfhi(a.y); x[4] = bflo(a.z); x[5] = bfhi(a.z); x[6] = bflo(a.w); x[7] = bfhi(a.w);
            x[8] = bflo(b2.x); x[9] = bfhi(b2.x); x[10] = bflo(b2.y); x[11] = bfhi(b2.y); x[12] = bflo(b2.z); x[13] = bfhi(b2.z); x[14] = bflo(b2.w); x[15] = bfhi(b2.w);
            float s = 0.f;
#pragma unroll
            for (int e = 0; e < 16; ++e) s += x[e];
            const float mean = wave_sum(s) * (1.f / D); float s2 = 0.f;
#pragma unroll
            for (int e = 0; e < 16; ++e) { const float d = x[e] - mean; s2 += d * d; }
            const float rstd = 1.f / sqrtf(wave_sum(s2) * (1.f / D) + LN_EPS);
            if (lane == 0) { st[row * 2] = mean; st[row * 2 + 1] = rstd; }
        }
        __syncthreads();
        const int qrow = tid >> 2, cseg = (tid & 3) * 16;
        const float mu = st[qrow * 2], rs = st[qrow * 2 + 1];
        for (int g = 0; g < 16; ++g) {
            LAS bf16* Tb = T + (g & 1) * 64 * SG_TS;
            {
                const v4u* p = (const v4u*)(Vb + (size_t)(128 * n + qrow) * D + 64 * g + cseg);
                const v4u a = p[0], b2 = p[1];
                float x[16];
                x[0] = bflo(a.x); x[1] = bfhi(a.x); x[2] = bflo(a.y); x[3] = bfhi(a.y); x[4] = bflo(a.z); x[5] = bfhi(a.z); x[6] = bflo(a.w); x[7] = bfhi(a.w);
                x[8] = bflo(b2.x); x[9] = bfhi(b2.x); x[10] = bflo(b2.y); x[11] = bfhi(b2.y); x[12] = bflo(b2.z); x[13] = bfhi(b2.z); x[14] = bflo(b2.w); x[15] = bfhi(b2.w);
#pragma unroll
                for (int e4 = 0; e4 < 4; ++e4) {
                    const f32x4 gg = *(const f32x4*)(lng + 64 * g + cseg + 4 * e4), bb = *(const f32x4*)(lnb + 64 * g + cseg + 4 * e4);
#pragma unroll
                    for (int e = 0; e < 4; ++e) { const float y = (x[4 * e4 + e] - mu) * rs * gg[e] + bb[e]; Tb[(cseg + 4 * e4 + e) * SG_TS + qrow] = (bf16)f2bf(y); }
                }
            }
            __syncthreads();
            bf16x8 Wf[4];
#pragma unroll
            for (int kk = 0; kk < 4; ++kk) Wf[kk] = *(const bf16x8*)(WsB + ((size_t)(g * 128 + 16 * wave + q) * 128 + 32 * kk + 8 * rq));
            const int p = 16 * wave + q;
            const float bsv = bs[g * 128 + p];
#pragma unroll
            for (int cb = 0; cb < 4; ++cb) {
                f32x4 Dv = (f32x4){0.f, 0.f, 0.f, 0.f};
#pragma unroll
                for (int kk = 0; kk < 4; ++kk) { const bf16x8 Tf = *(const LAS bf16x8*)(Tb + (16 * cb + q) * SG_TS + 32 * kk + 8 * rq);
                    Dv = __builtin_amdgcn_mfma_f32_16x16x32_bf16(Tf, Wf[kk], Dv, 0, 0, 0); }
                bf16* up = U + (size_t)(128 * n + p) * D + 64 * g + 16 * cb + 4 * rq;
                const v2u uw = *(const v2u*)up;
                v2u w; w.x = pk2(bflo(uw.x) * (Dv[0] + bsv), bfhi(uw.x) * (Dv[1] + bsv)); w.y = pk2(bflo(uw.y) * (Dv[2] + bsv), bfhi(uw.y) * (Dv[3] + bsv));
                *(v2u*)up = w;
            }
        }
        __syncthreads();
    }
}

struct Args {
    const float* xp; const float* xs;
    const float* na_w_in; const float* na_rpb; const float* na_w_out;
    const float* sg_w_in; const float* sg_ln_g; const float* sg_ln_b; const float* sg_w_s; const float* sg_b_s; const float* sg_w_out;
    const float* ln_mix_g; const float* ln_mix_b; const float* ffn_w_in; const float* ffn_w_out; const float* ln_ffn_g; const float* ln_ffn_b;
    float* out; unsigned char* ws;
    int ph_lo, ph_hi, coop, pad;
};

__global__ void __launch_bounds__(NTHREADS, 2) fwd_megakernel(Args a) {
    extern __shared__ __attribute__((aligned(16))) unsigned char lds_raw[];
    LAS unsigned char* lds = (LAS unsigned char*)lds_raw;
    cg::grid_group grid = cg::this_grid();
    const int G = gridDim.x, blk = blockIdx.x;
    const int NGW = G * NWAVES;
    unsigned char* ws = a.ws;
    bf16* XN = (bf16*)(ws + WS_XN);
    bf16* S0 = (bf16*)(ws + WS_S0); bf16* S1 = (bf16*)(ws + WS_S1); bf16* S2 = (bf16*)(ws + WS_S2);
    bf16* WMIX = (bf16*)(ws + WS_WMIX); bf16* WFFN = (bf16*)(ws + WS_WFFN);
    int ph = 0;
#define PHASE_BEGIN() if (ph >= a.ph_lo && ph < a.ph_hi) { int tid = threadIdx.x; asm volatile("" : "+v"(tid)); const int lane = tid & 63, wave = __builtin_amdgcn_readfirstlane(tid >> 6); \
        const int gw = blk * NWAVES + wave; LAS float* scr = (LAS float*)(lds + 49152 + wave * 8704); (void)lane; (void)gw; (void)scr;
#define PHASE_END() if (a.coop && ph + 1 < a.ph_hi) grid.sync(); } ++ph;

    PHASE_BEGIN()
        for (int j = 0; j < 2; ++j) {
            convert_matrix<0>(a.na_w_in + (size_t)j * 1024 * 3072, 1024, 3072, WMIX + WO_NAIN + (size_t)j * 3072 * 1024, scr, gw, NGW, lane);
            convert_matrix<0>(a.na_w_out + (size_t)j * 1024 * 1024, 1024, 1024, WMIX + WO_NAOUT + (size_t)j * 1024 * 1024, scr, gw, NGW, lane);
            convert_matrix<0>(a.sg_w_in + (size_t)j * 1024 * 2048, 1024, 2048, WMIX + WO_SGIN + (size_t)j * 2048 * 1024, scr, gw, NGW, lane);
            convert_matrix<0>(a.sg_w_out + (size_t)j * 1024 * 1024, 1024, 1024, WMIX + WO_SGOUT + (size_t)j * 1024 * 1024, scr, gw, NGW, lane);
        }
        {
            const int gt = blk * NTHREADS + tid, NT = G * NTHREADS;
            for (int i = gt; i < 2 * 16 * 128 * 128 / 8; i += NT) {
                const f32x4 v0 = ((const f32x4*)a.sg_w_s)[2 * i], v1 = ((const f32x4*)a.sg_w_s)[2 * i + 1];
                v4u o; o.x = pk2(v0.x, v0.y); o.y = pk2(v0.z, v0.w); o.z = pk2(v1.x, v1.y); o.w = pk2(v1.z, v1.w);
                ((v4u*)(WMIX + WO_SGWS))[i] = o;
            }
            for (int i = gt; i < MTOK * D / 8; i += NT) {
                const float* src = (i < NPROMPT * D / 8) ? (a.xp + (size_t)i * 8) : (a.xs + ((size_t)i * 8 - (size_t)NPROMPT * D));
                const f32x4 v0 = ((const f32x4*)src)[0], v1 = ((const f32x4*)src)[1];
                v4u o; o.x = pk2(v0.x, v0.y); o.y = pk2(v0.z, v0.w); o.z = pk2(v1.x, v1.y); o.w = pk2(v1.z, v1.w);
                ((v4u*)XN)[i] = o;
            }
        }
    PHASE_END()

    for (int layer = 0; layer < 4; ++layer) {
        const int j = layer >> 1;
        const bool is_na = (layer & 1) == 0;
        const float* base0 = (layer == 0) ? a.xp : a.out;
        const float* base1 = (layer == 0) ? (a.xs - (size_t)NPROMPT * D) : a.out;
        PHASE_BEGIN()
            if (is_na) {
                const bf16* WinT = WMIX + WO_NAIN + (size_t)j * 3072 * 1024;
                {   pg8::Gemm g{XN, WinT, MTOK, 2048, D}; pg8::StaticOrder S; S.init(MTOK, 2048, G, blk);
                    pg8::EpiBf16<0> E{S0, D, nullptr, D, (size_t)(WS_S1 - WS_S0) / 2, QSCALE};
                    pg8::gemm_phase<pg8::EpiBf16<0>, pg8::StaticOrder, true, true>(lds, g, S, E); }
                {   pg8::Gemm g{WinT + (size_t)2048 * 1024, XN, D, MTOK, D}; pg8::StaticOrder S; S.init(D, MTOK, G, blk);
                    pg8::EpiBf16<0> E{S2, MTOK, nullptr, 0, 0, 1.f};
                    pg8::gemm_phase<pg8::EpiBf16<0>, pg8::StaticOrder, true, true>(lds, g, S, E); }
            } else {
                pg8::Gemm g{XN, WMIX + WO_SGIN + (size_t)j * 2048 * 1024, MTOK, 2048, D}; pg8::StaticOrder S; S.init(MTOK, 2048, G, blk);
                pg8::EpiBf16<1> E{S0, D, nullptr, D, (size_t)(WS_S1 - WS_S0) / 2, 1.f};
                pg8::gemm_phase<pg8::EpiBf16<1>, pg8::StaticOrder, true, true>(lds, g, S, E);
            }
        PHASE_END()
        PHASE_BEGIN()
            convert_matrix<1>(a.ffn_w_in + (size_t)layer * 1024 * 5632, 1024, 5632, WFFN + WF_IN, scr, gw, NGW, lane);
            convert_matrix<0>(a.ffn_w_out + (size_t)layer * 2816 * 1024, 2816, 1024, WFFN + WF_OUT, scr, gw, NGW, lane);
            if (is_na) attn_phase(S0, S1, S2, a.na_rpb + (size_t)j * 16 * 15 * 31, lds, tid, wave, lane, G, blk);
            else sg_phase(S0, S1, WMIX + WO_SGWS + (size_t)j * 16 * 128 * 128, a.sg_b_s + (size_t)j * 16 * 128, a.sg_ln_g + (size_t)j * D, a.sg_ln_b + (size_t)j * D, lds, tid, wave, lane, G, blk);
        PHASE_END()
        PHASE_BEGIN()
            pg8::Gemm g{S0, WMIX + (is_na ? WO_NAOUT : WO_SGOUT) + (size_t)j * 1024 * 1024, MTOK, D, D}; pg8::StaticOrder S; S.init(MTOK, D, G, blk);
            pg8::EpiRes E{base0, base1, NPROMPT / 256, a.out, D, ALPHA};
            pg8::gemm_phase<pg8::EpiRes, pg8::StaticOrder, true, true>(lds, g, S, E);
        PHASE_END()
        PHASE_BEGIN()
            ln_rows(a.out, XN, a.ln_mix_g + (size_t)layer * D, a.ln_mix_b + (size_t)layer * D, gw, NGW, lane);
        PHASE_END()
        PHASE_BEGIN()
            pg8::Gemm g{XN, WFFN + WF_IN, MTOK, 2 * DFF, D}; pg8::StaticOrder S; S.init(MTOK, 2 * DFF, G, blk);
            pg8::EpiSwiglu E{S0, DFF};
            pg8::gemm_phase<pg8::EpiSwiglu, pg8::StaticOrder, true, true>(lds, g, S, E);
        PHASE_END()
        PHASE_BEGIN()
            pg8::Gemm g{S0, WFFN + WF_OUT, MTOK, D, DFF}; pg8::StaticOrder S; S.init(MTOK, D, G, blk);
            pg8::EpiRes E{a.out, a.out, NPROMPT / 256, a.out, D, ALPHA};
            pg8::gemm_phase<pg8::EpiRes, pg8::StaticOrder, true, true>(lds, g, S, E);
        PHASE_END()
        PHASE_BEGIN()
            ln_rows(a.out, XN, a.ln_ffn_g + (size_t)layer * D, a.ln_ffn_b + (size_t)layer * D, gw, NGW, lane);
        PHASE_END()
    }
#undef PHASE_BEGIN
#undef PHASE_END
}
constexpr int N_PHASES = 1 + 4 * 7;

extern "C" void kernel_launch(void* const* d_in, const int* in_sizes, int n_in, void* d_out, int out_size, void* d_ws, size_t ws_size, hipStream_t stream) {
    static int grid = 0;
    if (grid == 0) {
        int dev = 0, cus = 0, per_cu = 0;
        hipGetDevice(&dev);
        hipDeviceGetAttribute(&cus, hipDeviceAttributeMultiprocessorCount, dev);
        if (hipFuncSetAttribute((const void*)fwd_megakernel, hipFuncAttributeMaxDynamicSharedMemorySize, LDS_BYTES) != hipSuccess) fprintf(stderr, "kernel_launch: hipFuncSetAttribute failed\n");
        if (hipOccupancyMaxActiveBlocksPerMultiprocessor(&per_cu, (const void*)fwd_megakernel, NTHREADS, LDS_BYTES) != hipSuccess || per_cu < 1) { fprintf(stderr, "kernel_launch: occupancy query says %d\n", per_cu); per_cu = 1; }
        (void)hipGetLastError();
        grid = cus * per_cu;
        if (ws_size < WS_END) fprintf(stderr, "kernel_launch: workspace too small: %zu < %zu\n", ws_size, (size_t)WS_END);
    }
    Args a{};
    a.xp = (const float*)d_in[0]; a.xs = (const float*)d_in[1];
    a.na_w_in = (const float*)d_in[2]; a.na_rpb = (const float*)d_in[3]; a.na_w_out = (const float*)d_in[4];
    a.sg_w_in = (const float*)d_in[5]; a.sg_ln_g = (const float*)d_in[6]; a.sg_ln_b = (const float*)d_in[7]; a.sg_w_s = (const float*)d_in[8]; a.sg_b_s = (const float*)d_in[9]; a.sg_w_out = (const float*)d_in[10];
    a.ln_mix_g = (const float*)d_in[11]; a.ln_mix_b = (const float*)d_in[12]; a.ffn_w_in = (const float*)d_in[13]; a.ffn_w_out = (const float*)d_in[14]; a.ln_ffn_g = (const float*)d_in[15]; a.ln_ffn_b = (const float*)d_in[16];
    a.out = (float*)d_out; a.ws = (unsigned char*)d_ws;
    a.ph_lo = 0; a.ph_hi = N_PHASES; a.coop = 1; a.pad = 0;
    void* args[] = {&a};
    hipError_t e = hipLaunchCooperativeKernel((const void*)fwd_megakernel, dim3(grid), dim3(NTHREADS), args, LDS_BYTES, stream);
    if (e != hipSuccess) fprintf(stderr, "cooperative launch failed: %s (grid %d)\n", hipGetErrorString(e), grid);
}
```
